# Optimizing an MI355X kernel written in HIP

```python
import jax
import jax.numpy as jnp
from jax import lax
import numpy as np

D_MODEL = 1024
BATCH = 4
SEQ = 4096
DEPTH = 2

GRID_W = 64
CTX_LEN = 256
N_MOD = 9
D_FF = 2816
RMS_EPS = 1e-6
A_HEADS = 8
A_KV_HEADS = 2
A_HEAD_DIM = 64
WINDOW = 128
BLOCK = WINDOW
ROPE_BASE = 10000.0
B_HEADS = 4
B_DK = 64
B_DV = 128
B_GATE_RANK = 16
B_GATE_NORM = 16.0
B_CHUNK = 64
POOL_WINDOWS = (2, 4, 8, 16)
POOL_GROUP = D_MODEL // len(POOL_WINDOWS)
A_Q = A_HEADS * A_HEAD_DIM
A_KV = A_KV_HEADS * A_HEAD_DIM
B_QK = B_HEADS * B_DK
B_V = B_HEADS * B_DV
PROJ_SIZES = (A_Q, A_KV, A_KV, B_QK, B_QK, B_V, B_V, 2 * B_GATE_RANK)
PROJ_DIM = A_Q + 2 * A_KV + 2 * B_QK + 2 * B_V + 2 * B_GATE_RANK
MIX_OUT = A_Q + B_V

kernel_name = "hybrid_swa_gla_pool_prefix_dit"


def rmsnorm(x, g):
    x32 = x.astype(jnp.float32)
    y = x32 * lax.rsqrt(jnp.mean(x32 * x32, axis=-1, keepdims=True) + RMS_EPS)
    return y.astype(x.dtype) * g


def adaln(cond, w, b):
    mm = jax.nn.silu(cond) @ w + b
    mm = mm.reshape(mm.shape[:-1] + (N_MOD, mm.shape[-1] // N_MOD))
    return [mm[..., i, None, :] for i in range(N_MOD)]


def modulate(z, g, shift, scale):
    return rmsnorm(z, g) * (1.0 + scale) + shift


def swiglu(h, wi, wo):
    a, u = jnp.split(h @ wi, 2, axis=-1)
    return (jax.nn.silu(a) * u) @ wo


def _rotate(x, pos):
    n = x.shape[-1] // 2
    freqs = ROPE_BASE ** (-jnp.arange(n, dtype=jnp.float32) / n)
    ang = pos[:, None] * freqs
    cos = jnp.cos(ang)[:, None, :].astype(x.dtype)
    sin = jnp.sin(ang)[:, None, :].astype(x.dtype)
    x1, x2 = x[..., :n], x[..., n:]
    return jnp.concatenate([x1 * cos - x2 * sin, x2 * cos + x1 * sin], axis=-1)


def axial_rope(x, rows, cols):
    half = x.shape[-1] // 2
    return jnp.concatenate([_rotate(x[..., :half], rows), _rotate(x[..., half:], cols)], axis=-1)


def window_attention(q, k, v, kc, vc, sink):
    B, T, Hq, d = q.shape
    G = k.shape[2]
    R = Hq // G
    nb = T // BLOCK
    L = kc.shape[1]
    scale = d ** -0.5
    qb = q.reshape(B, nb, BLOCK, G, R, d)

    def band(a):
        ap = jnp.pad(a, ((0, 0), (BLOCK, BLOCK), (0, 0), (0, 0))).reshape(B, nb + 2, BLOCK, G, d)
        return jnp.concatenate([ap[:, :nb], ap[:, 1:nb + 1], ap[:, 2:]], axis=2)

    kb, vb = band(k), band(v)
    s_band = jnp.einsum('bnigrd,bnjgd->bgrnij', qb, kb).astype(jnp.float32) * scale
    s_ctx = jnp.einsum('bnigrd,blgd->bgrnil', qb, kc).astype(jnp.float32) * scale
    qpos = jnp.arange(nb)[:, None, None] * BLOCK + jnp.arange(BLOCK)[None, :, None]
    kpos = jnp.arange(nb)[:, None, None] * BLOCK - BLOCK + jnp.arange(3 * BLOCK)[None, None, :]
    valid = (kpos >= 0) & (kpos < T) & (jnp.abs(kpos - qpos) <= WINDOW)
    s_band = jnp.where(valid, s_band, -jnp.inf)
    sink_l = jnp.broadcast_to(sink.astype(jnp.float32).reshape(1, G, R, 1, 1, 1), s_band.shape[:-1] + (1,))
    p = jax.nn.softmax(jnp.concatenate([s_band, s_ctx, sink_l], axis=-1), axis=-1)
    nk = 3 * BLOCK
    o = (jnp.einsum('bgrnij,bnjgd->bnigrd', p[..., :nk].astype(vb.dtype), vb)
         + jnp.einsum('bgrnil,blgd->bnigrd', p[..., nk:nk + L].astype(vc.dtype), vc))
    return o.reshape(B, T, Hq * d)


def context_attention(qc, kc, vc, sink):
    B, L, Hq, d = qc.shape
    G = kc.shape[2]
    R = Hq // G
    s = jnp.einsum('blgrd,bmgd->bgrlm', qc.reshape(B, L, G, R, d), kc).astype(jnp.float32) * d ** -0.5
    sink_l = jnp.broadcast_to(sink.astype(jnp.float32).reshape(1, G, R, 1, 1), s.shape[:-1] + (1,))
    p = jax.nn.softmax(jnp.concatenate([s, sink_l], axis=-1), axis=-1)
    o = jnp.einsum('bgrlm,bmgd->blgrd', p[..., :L].astype(vc.dtype), vc)
    return o.reshape(B, L, Hq * d)


def gla_chunked(q, k, v, log_a, s0):
    B, T, H, dk = q.shape
    C = B_CHUNK
    n = T // C
    f32 = jnp.float32

    def chunks(a):
        return a.astype(f32).reshape(B, n, C, H, a.shape[-1])

    qc_ = chunks(q) * dk ** -0.5
    kc_ = chunks(k)
    vc_ = chunks(v)
    g = jnp.cumsum(chunks(log_a), axis=2)
    g_last = g[:, :, -1:]
    q_t = qc_ * jnp.exp(g)
    k_t = kc_ * jnp.exp(-g)
    k_end = kc_ * jnp.exp(g_last - g)
    lower = jnp.tril(jnp.ones((C, C), dtype=bool))
    att = jnp.where(lower, jnp.einsum('bnihd,bnjhd->bnhij', q_t, k_t), 0.0)
    o = jnp.einsum('bnhij,bnjhv->bnihv', att, vc_)
    d_state = jnp.einsum('bnjhd,bnjhv->bnhdv', k_end, vc_)
    decay = jnp.exp(g_last[:, :, 0])

    def step(S, inp):
        dec, ds = inp
        return dec[..., None] * S + ds, S

    s_final, s_prev = lax.scan(step, s0, (jnp.moveaxis(decay, 1, 0), jnp.moveaxis(d_state, 1, 0)))
    s_prev = jnp.moveaxis(s_prev, 0, 1)
    o = o + jnp.einsum('bnihd,bnhdv->bnihv', q_t, s_prev)
    return o.reshape(B, T, H, v.shape[-1]).astype(q.dtype), s_final


def bidir_gla(q, k, v, la_f, la_b, qc, kc, vc, lac_f, lac_b):
    flip = lambda a: a[:, ::-1]
    B = q.shape[0]
    zeros = jnp.zeros((B, B_HEADS, B_DK, B_DV), jnp.float32)
    oc_f, sc_f = gla_chunked(qc, kc, vc, lac_f, zeros)
    oc_b, sc_b = gla_chunked(flip(qc), flip(kc), flip(vc), flip(lac_b), zeros)
    o_f, _ = gla_chunked(q, k, v, la_f, sc_f)
    o_b, _ = gla_chunked(flip(q), flip(k), flip(v), flip(la_b), sc_b)
    return o_f + flip(o_b), oc_f + flip(oc_b)


def gla_output(o, r, gla_g):
    B, T = o.shape[:2]
    return rmsnorm(o, gla_g).reshape(B, T, B_V) * jax.nn.silu(r)


def mixer_ab(h, hc, rows, cols, need_ctx_out, w_in, w_a2_f, b_a_f, w_a2_b, b_a_b, sink, gla_g, w_out):
    split_points = [int(s) for s in np.cumsum(PROJ_SIZES)[:-1]]

    def project(z):
        Bz, Tz = z.shape[:2]
        qa, ka, va, qb, kb, vb, rb, zg = jnp.split(z @ w_in, split_points, axis=-1)
        la_f = jax.nn.log_sigmoid((zg[..., :B_GATE_RANK] @ w_a2_f + b_a_f).astype(jnp.float32)) / B_GATE_NORM
        la_b = jax.nn.log_sigmoid((zg[..., B_GATE_RANK:] @ w_a2_b + b_a_b).astype(jnp.float32)) / B_GATE_NORM
        return (qa.reshape(Bz, Tz, A_HEADS, A_HEAD_DIM),
                ka.reshape(Bz, Tz, A_KV_HEADS, A_HEAD_DIM),
                va.reshape(Bz, Tz, A_KV_HEADS, A_HEAD_DIM),
                qb.reshape(Bz, Tz, B_HEADS, B_DK),
                kb.reshape(Bz, Tz, B_HEADS, B_DK),
                vb.reshape(Bz, Tz, B_HEADS, B_DV),
                rb,
                la_f.reshape(Bz, Tz, B_HEADS, B_DK),
                la_b.reshape(Bz, Tz, B_HEADS, B_DK))

    qa, ka, va, qb, kb, vb, rb, la_f, la_b = project(h)
    cqa, cka, cva, cqb, ckb, cvb, crb, cla_f, cla_b = project(hc)
    o_a = window_attention(axial_rope(qa, rows, cols), axial_rope(ka, rows, cols), va, cka, cva, sink)
    o_b, oc_b = bidir_gla(qb, kb, vb, la_f, la_b, cqb, ckb, cvb, cla_f, cla_b)
    y = jnp.concatenate([o_a, gla_output(o_b, rb, gla_g)], axis=-1) @ w_out
    yc = None
    if need_ctx_out:
        oc_a = context_attention(cqa, cka, cva, sink)
        yc = jnp.concatenate([oc_a, gla_output(oc_b, crb, gla_g)], axis=-1) @ w_out
    return y, yc


def pool_mixer(h, w_pool, pool_scale):
    B, T, D = h.shape
    ng = len(POOL_WINDOWS)
    hg = h.astype(jnp.float32).reshape(B, T, ng, POOL_GROUP)
    prefix = jnp.pad(jnp.cumsum(hg, axis=1), ((0, 0), (1, 0), (0, 0), (0, 0)))
    t = jnp.arange(T)
    means = []
    for gi, w in enumerate(POOL_WINDOWS):
        lo = jnp.maximum(t - w // 2, 0)
        hi = jnp.minimum(t + (w - w // 2), T)
        total = prefix[:, hi, gi] - prefix[:, lo, gi]
        means.append(total / (hi - lo).astype(jnp.float32)[:, None])
    pooled = (jnp.stack(means, axis=2) - hg).astype(h.dtype)
    y = jnp.einsum('btgc,gce->btge', pooled, w_pool)
    return y.reshape(B, T, D) * pool_scale


def setup_inputs(seed: int = 0) -> dict:
    key = jax.random.key(seed)
    ks = jax.random.split(key, 24)
    D = D_MODEL
    ne = (DEPTH + 1) // 2
    no = DEPTH // 2

    def nrm(k, shape, scale=1.0):
        return jax.random.normal(k, shape, jnp.float32) * scale

    return {
        "x": nrm(ks[0], (BATCH, SEQ, D)),
        "c": nrm(ks[1], (BATCH, D)),
        "ctx": nrm(ks[2], (BATCH, CTX_LEN, D)),
        "c_ctx": nrm(ks[3], (D,)),
        "w_mod": nrm(ks[4], (DEPTH, D, N_MOD * D), 0.5 * D ** -0.5),
        "b_mod": nrm(ks[5], (DEPTH, N_MOD * D), 0.01),
        "norm_g": 1.0 + nrm(ks[6], (DEPTH, 3, D), 0.05),
        "ffn1_wi": nrm(ks[7], (DEPTH, D, 2 * D_FF), D ** -0.5),
        "ffn1_wo": nrm(ks[8], (DEPTH, D_FF, D), D_FF ** -0.5),
        "ffn2_wi": nrm(ks[9], (DEPTH, D, 2 * D_FF), D ** -0.5),
        "ffn2_wo": nrm(ks[10], (DEPTH, D_FF, D), D_FF ** -0.5),
        "w_in": nrm(ks[11], (ne, D, PROJ_DIM), D ** -0.5),
        "w_a2_f": nrm(ks[12], (ne, B_GATE_RANK, B_QK), B_GATE_RANK ** -0.5),
        "b_a_f": nrm(ks[13], (ne, B_QK), 0.1),
        "w_a2_b": nrm(ks[14], (ne, B_GATE_RANK, B_QK), B_GATE_RANK ** -0.5),
        "b_a_b": nrm(ks[15], (ne, B_QK), 0.1),
        "sink": nrm(ks[16], (ne, A_HEADS), 1.0),
        "gla_g": 1.0 + nrm(ks[17], (ne, B_DV), 0.05),
        "w_out": nrm(ks[18], (ne, MIX_OUT, D), MIX_OUT ** -0.5),
        "w_pool": nrm(ks[19], (no, len(POOL_WINDOWS), POOL_GROUP, POOL_GROUP), POOL_GROUP ** -0.5),
        "pool_scale": 1.0 + nrm(ks[20], (no, D), 0.1),
        "final_g": 1.0 + nrm(ks[21], (D,), 0.05),
    }


def reference(x, c, ctx, c_ctx, w_mod, b_mod, norm_g, ffn1_wi, ffn1_wo, ffn2_wi, ffn2_wo,
              w_in, w_a2_f, b_a_f, w_a2_b, b_a_b, sink, gla_g, w_out, w_pool, pool_scale, final_g):
    T = x.shape[1]
    ROWS = T // GRID_W
    rows = jnp.repeat(jnp.arange(ROWS, dtype=jnp.float32), GRID_W)
    cols = jnp.tile(jnp.arange(GRID_W, dtype=jnp.float32), ROWS)

    for l in range(DEPTH):
        even = l % 2 == 0
        ctx_out = any(j % 2 == 0 for j in range(l + 1, DEPTH))
        ctx_in = even or ctx_out
        m = adaln(c, w_mod[l], b_mod[l])
        mc = adaln(c_ctx, w_mod[l], b_mod[l]) if ctx_in else None

        x = x + 0.5 * m[2] * swiglu(modulate(x, norm_g[l, 0], m[0], m[1]), ffn1_wi[l], ffn1_wo[l])
        if ctx_in:
            ctx = ctx + 0.5 * mc[2] * swiglu(modulate(ctx, norm_g[l, 0], mc[0], mc[1]), ffn1_wi[l], ffn1_wo[l])

        h = modulate(x, norm_g[l, 1], m[3], m[4])
        if even:
            e = l // 2
            hc = modulate(ctx, norm_g[l, 1], mc[3], mc[4])
            y, yc = mixer_ab(h, hc, rows, cols, ctx_out, w_in[e], w_a2_f[e], b_a_f[e], w_a2_b[e], b_a_b[e],
                             sink[e], gla_g[e], w_out[e])
        else:
            o = l // 2
            y = pool_mixer(h, w_pool[o], pool_scale[o])
            yc = pool_mixer(modulate(ctx, norm_g[l, 1], mc[3], mc[4]), w_pool[o], pool_scale[o]) if ctx_out else None
        x = x + m[5] * y
        if ctx_out:
            ctx = ctx + mc[5] * yc

        x = x + 0.5 * m[8] * swiglu(modulate(x, norm_g[l, 2], m[6], m[7]), ffn2_wi[l], ffn2_wo[l])
        if ctx_out:
            ctx = ctx + 0.5 * mc[8] * swiglu(modulate(ctx, norm_g[l, 2], mc[6], mc[7]), ffn2_wi[l], ffn2_wo[l])

    return rmsnorm(x, final_g)
```

```cpp
#include <hip/hip_runtime.h>
#include <cstdio>
#include <cstdint>


constexpr int NWAVES = 8;
constexpr int D = 1024, BATCH = 4, SEQ = 4096, XROWS = BATCH * SEQ, CTXL = 256, CROWS = BATCH * CTXL, MROWS = XROWS + CROWS;
constexpr int DFF = 2816, NWI = 2 * DFF, NPROJ = 2336, NPROJ_PAD = 2560, NMOD = 9;
constexpr float RMS_EPS = 1e-6f;
constexpr int KSPLIT = 16;

constexpr size_t MiB = 1u << 20;
constexpr size_t WS_CTL = 0, CTL_ZERO_BYTES = 1 * MiB;
constexpr size_t WS_MTAB = 1 * MiB;
constexpr size_t WS_ROPE = 1 * MiB + 512 * 1024;
constexpr size_t WS_MPART = 2 * MiB;
constexpr size_t WS_CTX1 = 8 * MiB;
constexpr size_t WS_WI = 12 * MiB;
constexpr size_t WS_WO = 56 * MiB;
constexpr size_t WS_WIN = 78 * MiB;
constexpr size_t WS_WOUT = 83 * MiB;
constexpr size_t WS_WPOOL = 85 * MiB;
constexpr size_t WS_XN = 86 * MiB;
constexpr size_t WS_MIX = 120 * MiB;
constexpr size_t WS_H = 152 * MiB;
constexpr size_t WS_Q = WS_H, WS_K = WS_H + 16 * MiB, WS_V = WS_H + 21 * MiB, WS_QB = WS_H + 26 * MiB, WS_KB = WS_H + 35 * MiB,
                 WS_VB = WS_H + 44 * MiB, WS_RB = WS_H + 61 * MiB, WS_ZG = WS_H + 77 * MiB;
constexpr size_t WS_GS = 246 * MiB;
constexpr size_t WS_GD = 263 * MiB;
constexpr size_t WS_END = 264 * MiB;
static_assert(WS_H + (size_t)MROWS * DFF * 2 <= WS_GS, "H fits");

constexpr int CW_TMO = 0, CW_CODE = 1, CW_BAR = 4096;

constexpr int RING_OFF = 0, RING_BYTES = 131072;
constexpr int LDSCTL_OFF = RING_BYTES, MISC_OFF = LDSCTL_OFF + 320;
constexpr int LDS_BYTES = 147456;
static_assert(MISC_OFF + 128 <= LDS_BYTES, "LDS map");

#define GAS __attribute__((address_space(1)))
#define LAS __attribute__((address_space(3)))
typedef unsigned short bf16;
typedef unsigned v4u __attribute__((ext_vector_type(4)));
typedef unsigned v2u __attribute__((ext_vector_type(2)));
typedef float f32x4 __attribute__((ext_vector_type(4)));
typedef float f32x16 __attribute__((ext_vector_type(16)));
typedef short bf16x8 __attribute__((ext_vector_type(8)));
typedef short s16x4 __attribute__((ext_vector_type(4)));
typedef GAS unsigned gu32;
#define RLX_AGENT __ATOMIC_RELAXED, __HIP_MEMORY_SCOPE_AGENT
#define LDS_WAIT() asm volatile("s_waitcnt lgkmcnt(0)" ::: "memory")
#define VM_WAIT() asm volatile("s_waitcnt vmcnt(0)" ::: "memory")
__device__ __forceinline__ unsigned f2bf(float f) { unsigned u = __builtin_bit_cast(unsigned, f); return (u + 0x7fffu + ((u >> 16) & 1u)) >> 16; }
__device__ __forceinline__ unsigned pk2(float lo, float hi) { return f2bf(lo) | (f2bf(hi) << 16); }
__device__ __forceinline__ float bf2f(unsigned short b) { return __builtin_bit_cast(float, (unsigned)b << 16); }
__device__ __forceinline__ float bflo(unsigned w) { return __builtin_bit_cast(float, w << 16); }
__device__ __forceinline__ float bfhi(unsigned w) { return __builtin_bit_cast(float, w & 0xffff0000u); }
__device__ __forceinline__ int crow(int r, int hi) { return (r & 3) + 8 * (r >> 2) + 4 * hi; }
__device__ __forceinline__ f32x16 mfma32(bf16x8 a, bf16x8 b, f32x16 c) { return __builtin_amdgcn_mfma_f32_32x32x16_bf16(a, b, c, 0, 0, 0); }

#define KAS __attribute__((address_space(4)))
__device__ __forceinline__ const unsigned char KAS* karg_base() { const unsigned char KAS* kp = (const unsigned char KAS*)__builtin_amdgcn_kernarg_segment_ptr(); asm volatile("" : "+s"(kp)); return kp; }
__device__ __forceinline__ const float* IN(int k) { return *(const float* const KAS*)(karg_base() + 8 * k); }
__device__ __forceinline__ float* OUTP() { return *(float* const KAS*)(karg_base() + 176); }
__device__ __forceinline__ unsigned char* WSP() { return *(unsigned char* const KAS*)(karg_base() + 184); }

namespace pg8 {
#define PG8_LAS __attribute__((address_space(3)))
typedef unsigned short bf16_t;
typedef short bf16x8 __attribute__((ext_vector_type(8)));
typedef float f32x4 __attribute__((ext_vector_type(4)));
typedef float f32x2 __attribute__((ext_vector_type(2)));
typedef unsigned u32x4 __attribute__((ext_vector_type(4)));
constexpr int BM = 256, BK = 64, HALF = 128, HTB = HALF * BK * 2  , STAGE_BYTES = 8 * HTB, NXCD = 8, WGM = 8;

__host__ __device__ __forceinline__ int lds_byte(int r, int c) { const int st = (r >> 4) * 2 + (c >> 5), rr = r & 15, cc = c & 31, ob = rr * 64 + cc * 2; return st * 1024 + (ob ^ (((ob >> 9) & 1) << 5)); }
__host__ __device__ __forceinline__ void stage_rc(int b, int& R, int& C) { const int st = b / 1024, sb = b % 1024, swz = sb ^ (((sb >> 9) & 1) << 5); R = (st >> 1) * 16 + swz / 64; C = (st & 1) * 32 + (swz % 64) / 2; }
__host__ __device__ __forceinline__ int perm32(int rho) { const int n = rho >> 4, i = rho & 15; return 8 * (i >> 2) + 4 * n + (i & 3); }

struct Unit { int pm, pn; };
struct Gemm { const bf16_t* A; const bf16_t* Bt; int M, N, K, lda, apn; };

struct StaticOrder {
    int nM, nN, nwg, G, c;
    __host__ __device__ void init(int M, int N, int G_, int c_) { nM = M / BM; nN = N / BM; nwg = nM * nN; G = G_; c = c_; }
    __host__ __device__ bool next(int i, Unit& u) const {
        const long L = (long)i * G + c; if (L >= nwg) return false;
        int wgid = (int)L; { const int q = nwg / NXCD, r = nwg % NXCD, xcd = wgid % NXCD, off = wgid / NXCD; wgid = (xcd < r ? xcd * (q + 1) : r * (q + 1) + (xcd - r) * q) + off; }
        const int nig = WGM * nN, gid = wgid / nig, fm = gid * WGM, gsz = (nM - fm) < WGM ? (nM - fm) : WGM;
        u.pm = fm + ((wgid % nig) % gsz); u.pn = (wgid % nig) / gsz; return true;
    }
    __device__ __forceinline__ void a_ready(const Unit&) const {}
    __device__ __forceinline__ void done(const Unit&) const {}
};

__device__ __forceinline__ unsigned cvt_pk_bf16(float lo, float hi) { unsigned r; asm volatile("v_cvt_pk_bf16_f32 %0, %1, %2" : "=v"(r) : "v"(lo), "v"(hi)); return r; }
__device__ __forceinline__ float silu_f(float a) { return a * __builtin_amdgcn_rcpf(1.0f + __builtin_amdgcn_exp2f(-1.4426950408889634f * a)); }

constexpr int XROWS = 16384;
constexpr int MT_STRIDE = 9216;
#define PG8_OPAQUE_V(x) asm volatile("" : "+v"(x))

struct EpiSwiGLU {
    static constexpr bool PERM = true, AFTER_DRAIN = false;
    __device__ __forceinline__ void operator()(const f32x4 (&acc)[2][2][4][2], const Unit& u, int wr, int wc, int fr, int fq) const {
        PG8_OPAQUE_V(fr);
        bf16_t* const O = (bf16_t*)(WSP() + WS_H);
        const int row0 = u.pm * BM + wr * 64 + fr, col0 = u.pn * HALF + wc * 32 + 8 * fq;
#pragma unroll
        for (int ai = 0; ai < 2; ++ai)
#pragma unroll
            for (int m = 0; m < 4; ++m) { bf16_t* rowp = O + (size_t)(row0 + ai * HALF + m * 16) * DFF + col0;
                const f32x4 a0 = acc[ai][0][m][0], a1 = acc[ai][0][m][1], u0 = acc[ai][1][m][0], u1 = acc[ai][1][m][1];
                u32x4 w;
                w.x = cvt_pk_bf16(silu_f(a0[0]) * u0[0], silu_f(a0[1]) * u0[1]); w.y = cvt_pk_bf16(silu_f(a0[2]) * u0[2], silu_f(a0[3]) * u0[3]);
                w.z = cvt_pk_bf16(silu_f(a1[0]) * u1[0], silu_f(a1[1]) * u1[1]); w.w = cvt_pk_bf16(silu_f(a1[2]) * u1[2], silu_f(a1[3]) * u1[3]);
                *(u32x4*)rowp = w; }
    }
};

struct EpiRes {
    static constexpr bool PERM = false, AFTER_DRAIN = false;
    int base_is_input, mt_off, use_ps; float gsc;
    __device__ __forceinline__ void operator()(const f32x4 (&acc)[2][2][4][2], const Unit& u, int wr, int wc, int fr, int fq) const {
        PG8_OPAQUE_V(fr);
        unsigned char* const ws = WSP(); float* const X = OUTP();
        const bool isctx = u.pm >= 64; const int r = isctx ? 4 : (u.pm >> 4);
        const int rowl0 = (isctx ? (u.pm - 64) : u.pm) * BM + wr * 64 + fr, col0 = u.pn * BM + wc * 32 + 4 * fq;
        const float* base = isctx ? IN(2) : (base_is_input ? IN(0) : X); float* out = isctx ? (float*)(ws + WS_CTX1) : X;
        const float* mtab = (const float*)(ws + WS_MTAB) + mt_off; const float* ps = IN(20);
        f32x4 gv[2][2];
#pragma unroll
        for (int bj = 0; bj < 2; ++bj)
#pragma unroll
            for (int n = 0; n < 2; ++n) { f32x4 g = *(const f32x4*)(mtab + (size_t)r * MT_STRIDE + col0 + bj * HALF + n * 16) * gsc;
                if (use_ps) g = g * *(const f32x4*)(ps + col0 + bj * HALF + n * 16); gv[bj][n] = g; }
#pragma unroll
        for (int ai = 0; ai < 2; ++ai)
#pragma unroll
            for (int m = 0; m < 4; ++m) { const size_t off = (size_t)(rowl0 + ai * HALF + m * 16) * 1024 + col0;
#pragma unroll
                for (int bj = 0; bj < 2; ++bj)
#pragma unroll
                    for (int n = 0; n < 2; ++n) { const f32x4 bs = *(const f32x4*)(base + off + bj * HALF + n * 16);
                        *(f32x4*)(out + off + bj * HALF + n * 16) = bs + gv[bj][n] * acc[ai][bj][m][n]; } }
    }
};

constexpr float QK_C2 = 0.125f * 1.4426950408889634f;
struct EpiProj {
    static constexpr bool PERM = true, AFTER_DRAIN = false;
    __device__ __forceinline__ void operator()(const f32x4 (&acc)[2][2][4][2], const Unit& u, int wr, int wc, int fr, int fq) const {
        const int pn = u.pn; const bool isctx = u.pm >= 64;
        if (isctx && (pn == 0 || pn == 1 || pn == 3 || pn == 7 || pn == 8)) return;
        PG8_OPAQUE_V(fr);
        unsigned char* const ws = WSP(); const float* const rope = (const float*)(ws + WS_ROPE);
        const int row0 = u.pm * BM + wr * 64 + fr;
        size_t dbase; int pitch, c0;
        if (pn <= 1) { dbase = WS_Q; pitch = 512; c0 = pn * 256; } else if (pn == 2) { dbase = WS_K; pitch = 128; c0 = 0; } else if (pn == 3) { dbase = WS_QB; pitch = 256; c0 = 0; }
        else if (pn == 4) { dbase = WS_KB; pitch = 256; c0 = 0; } else if (pn <= 6) { dbase = WS_VB; pitch = 512; c0 = (pn - 5) * 256; } else { dbase = WS_RB; pitch = 512; c0 = (pn - 7) * 256; }
        if (pn == 9) { if (wc == 0) {
#pragma unroll
                for (int ai = 0; ai < 2; ++ai)
#pragma unroll
                    for (int m = 0; m < 4; ++m) { float* z = (float*)(ws + WS_ZG) + (size_t)(row0 + ai * HALF + m * 16) * 32 + 8 * fq; *(f32x4*)z = acc[ai][0][m][0]; *(f32x4*)(z + 4) = acc[ai][0][m][1]; } }
            return; }
        const bool rot = (pn <= 2) && !isctx;
#pragma unroll
        for (int ai = 0; ai < 2; ++ai)
#pragma unroll
            for (int m = 0; m < 4; ++m) { const int row = row0 + ai * HALF + m * 16; const int t = row & 4095;
                const int pos = (wc & 1) ? (t & 63) : (t >> 6);
                f32x4 cs = (f32x4){1.f, 1.f, 1.f, 1.f}, sn = (f32x4){0.f, 0.f, 0.f, 0.f};
                if (rot) { cs = *(const f32x4*)(rope + pos * 16 + 4 * fq); sn = *(const f32x4*)(rope + 1024 + pos * 16 + 4 * fq); }
#pragma unroll
                for (int bj = 0; bj < 2; ++bj) { f32x4 v0 = acc[ai][bj][m][0], v1 = acc[ai][bj][m][1];
                    bf16_t* dst = (bf16_t*)(ws + dbase) + (size_t)row * pitch + c0 + bj * HALF + wc * 32 + 8 * fq;
                    if (pn <= 1) { const f32x4 o0 = (v0 * cs - v1 * sn) * QK_C2, o1 = (v1 * cs + v0 * sn) * QK_C2; v0 = o0; v1 = o1; }
                    else if (pn == 2) { if (bj == 0) { const f32x4 o0 = v0 * cs - v1 * sn, o1 = v1 * cs + v0 * sn; v0 = o0; v1 = o1; dst = (bf16_t*)(ws + WS_K) + (size_t)row * 128 + wc * 32 + 8 * fq; }
                                        else dst = (bf16_t*)(ws + WS_V) + (size_t)row * 128 + wc * 32 + 8 * fq; }
                    u32x4 w; w.x = cvt_pk_bf16(v0[0], v0[1]); w.y = cvt_pk_bf16(v0[2], v0[3]); w.z = cvt_pk_bf16(v1[0], v1[1]); w.w = cvt_pk_bf16(v1[2], v1[3]);
                    *(u32x4*)dst = w; } }
    }
};

template <class Epi, class Sched, bool ALIGN_EPI = false, bool SP2 = false>
__device__ __forceinline__ void gemm_phase(PG8_LAS unsigned char* lds, const Gemm g, const Sched& S, const Epi& E) {
    int tid_ = threadIdx.x; asm volatile("" : "+v"(tid_));
    const int tid = tid_, wid = __builtin_amdgcn_readfirstlane(tid >> 6), lane = tid & 63, wr = wid >> 2, wc = wid & 3, fr = lane & 15, fq = lane >> 4;
    const int K = g.K, nt = K / BK, lda = g.lda;
    unsigned voffA[2], voffB[2];
#pragma unroll
    for (int i = 0; i < 2; ++i) { int R, C; stage_rc(tid * 16 + i * 8192, R, C); const int Rb = Epi::PERM ? ((R & ~31) + perm32(R & 31)) : R;
        voffA[i] = (unsigned)(R * lda + C) * 2u; voffB[i] = (unsigned)(Rb * K + C) * 2u; }
    const size_t kstep = (size_t)(BK * 2);
    const size_t hstepA = (size_t)HALF * lda * 2, hstepB = (size_t)HALF * K * 2;
    const size_t tstepA = 2 * hstepA, tstepB = 2 * hstepB; const size_t apn2 = (size_t)g.apn * 2;
    const unsigned ldsw = (unsigned)wid * 1024u;
    const int aoff = lds_byte(wr * 64 + fr, fq * 8), boff = lds_byte(wc * 32 + fr, fq * 8);
#define PG8_SA(b, h) (((b) * 2 + (h)) * HTB)
#define PG8_SB(b, h) ((4 + (b) * 2 + (h)) * HTB)
#define PG8_STAGE(bufoff, gbase, voff) do { _Pragma("unroll") for (int _i = 0; _i < 2; ++_i) \
        __builtin_amdgcn_global_load_lds((const unsigned*)((const char*)(gbase) + (voff)[_i]), (PG8_LAS unsigned*)(lds + (bufoff) + ldsw + _i * 8192), 16, 0, 0); } while (0)
#define PG8_LDA(dst, b, h) do { _Pragma("unroll") for (int m = 0; m < 4; ++m) _Pragma("unroll") for (int k = 0; k < 2; ++k) dst[m][k] = *(const PG8_LAS bf16x8*)(lds + PG8_SA(b, h) + aoff + m * 2048 + k * 1024); } while (0)
#define PG8_LDB(dst, b, h) do { _Pragma("unroll") for (int n = 0; n < 2; ++n) _Pragma("unroll") for (int k = 0; k < 2; ++k) dst[n][k] = *(const PG8_LAS bf16x8*)(lds + PG8_SB(b, h) + boff + n * 2048 + k * 1024); } while (0)
#define PG8_MMA(ai, bj, At, Bt) do { __builtin_amdgcn_s_setprio(1); _Pragma("unroll") for (int m = 0; m < 4; ++m) _Pragma("unroll") for (int n = 0; n < 2; ++n) _Pragma("unroll") for (int k = 0; k < 2; ++k) \
        acc[ai][bj][m][n] = __builtin_amdgcn_mfma_f32_16x16x32_bf16(Bt[n][k], At[m][k], acc[ai][bj][m][n], 0, 0, 0); __builtin_amdgcn_s_setprio(0); } while (0)
#define PG8_WAIT_V(n) asm volatile("s_waitcnt vmcnt(" #n ")" ::: "memory")
#define PG8_WAIT_L(n) asm volatile("s_waitcnt lgkmcnt(" #n ")" ::: "memory")
#define PG8_BAR __builtin_amdgcn_s_barrier()
#define PG8_SCHED __builtin_amdgcn_sched_barrier(0)
    Unit cur, nxt; int ui = 0;
    if (!S.next(0, cur)) return;
    f32x4 acc[2][2][4][2];
#pragma unroll
    for (int a = 0; a < 2; ++a)
#pragma unroll
        for (int b = 0; b < 2; ++b)
#pragma unroll
            for (int m = 0; m < 4; ++m)
#pragma unroll
                for (int n = 0; n < 2; ++n) acc[a][b][m][n] = (f32x4){0.f, 0.f, 0.f, 0.f};
    bf16x8 At[4][2], B0[2][2], B1[2][2];
    const char* cA = (const char*)g.A + (size_t)cur.pm * tstepA + (size_t)cur.pn * apn2; const char* cB = (const char*)g.Bt + (size_t)cur.pn * tstepB;
    S.a_ready(cur);
    if constexpr (SP2) {
        PG8_STAGE(PG8_SB(0, 0), cB, voffB); PG8_STAGE(PG8_SB(0, 1), cB + hstepB, voffB); PG8_STAGE(PG8_SA(0, 0), cA, voffA); PG8_STAGE(PG8_SA(0, 1), cA + hstepA, voffA);
        if (wr == 1) PG8_BAR;
        PG8_WAIT_V(2); PG8_BAR;
        PG8_STAGE(PG8_SB(1, 0), cB + kstep, voffB); PG8_STAGE(PG8_SA(1, 0), cA + kstep, voffA); PG8_STAGE(PG8_SB(1, 1), cB + hstepB + kstep, voffB);
        PG8_WAIT_V(6); PG8_BAR;
    } else {
        PG8_STAGE(PG8_SB(0, 0), cB, voffB); PG8_STAGE(PG8_SA(0, 0), cA, voffA); PG8_STAGE(PG8_SB(0, 1), cB + hstepB, voffB); PG8_STAGE(PG8_SA(0, 1), cA + hstepA, voffA);
        if (wr == 1) PG8_BAR;
        PG8_WAIT_V(4); PG8_BAR;
        PG8_STAGE(PG8_SB(1, 0), cB + kstep, voffB); PG8_STAGE(PG8_SA(1, 0), cA + kstep, voffA); PG8_STAGE(PG8_SB(1, 1), cB + hstepB + kstep, voffB);
        PG8_WAIT_V(6); PG8_BAR;
    }
    for (;;) {
        const bool has_next = S.next(ui + 1, nxt);
        const char* nA = has_next ? (const char*)g.A + (size_t)nxt.pm * tstepA + (size_t)nxt.pn * apn2 : cA; const char* nB = has_next ? (const char*)g.Bt + (size_t)nxt.pn * tstepB : cB;
        for (int t = 0; t < nt; t += 2) {
            const bool last = (t == nt - 2);
            const char* a1 = cA + (size_t)(t + 1) * kstep;
            const char* a2 = last ? nA : cA + (size_t)(t + 2) * kstep; const char* b2 = last ? nB : cB + (size_t)(t + 2) * kstep;
            const char* a3 = a2 + kstep; const char* b3 = b2 + kstep;
            if (last && has_next) S.a_ready(nxt);
            if constexpr (SP2) {
            PG8_LDB(B0, 0, 0); PG8_LDB(B1, 0, 1); PG8_SCHED; PG8_LDA(At, 0, 0); PG8_STAGE(PG8_SA(1, 1), a1 + hstepA, voffA);
            PG8_WAIT_V(8); PG8_WAIT_L(0); PG8_BAR; PG8_MMA(0, 0, At, B0); PG8_MMA(0, 1, At, B1); PG8_BAR; PG8_SCHED;
            PG8_LDA(At, 0, 1); PG8_STAGE(PG8_SB(0, 0), b2, voffB); PG8_STAGE(PG8_SB(0, 1), b2 + hstepB, voffB); PG8_STAGE(PG8_SA(0, 0), a2, voffA);
            PG8_WAIT_V(8); PG8_WAIT_L(0); PG8_BAR; PG8_MMA(1, 0, At, B0); PG8_MMA(1, 1, At, B1); PG8_BAR; PG8_SCHED;
            PG8_LDB(B0, 1, 0); PG8_LDB(B1, 1, 1); PG8_SCHED; PG8_LDA(At, 1, 0); PG8_STAGE(PG8_SA(0, 1), a2 + hstepA, voffA);
            PG8_WAIT_V(8); PG8_WAIT_L(0); PG8_BAR; PG8_MMA(0, 0, At, B0); PG8_MMA(0, 1, At, B1); PG8_BAR; PG8_SCHED;
            PG8_LDA(At, 1, 1); PG8_STAGE(PG8_SB(1, 0), b3, voffB); PG8_STAGE(PG8_SB(1, 1), b3 + hstepB, voffB); PG8_STAGE(PG8_SA(1, 0), a3, voffA);
            PG8_WAIT_V(8); PG8_WAIT_L(0); PG8_BAR; PG8_MMA(1, 0, At, B0); PG8_MMA(1, 1, At, B1); PG8_BAR; PG8_SCHED;
            } else {
            PG8_LDB(B0, 0, 0); PG8_SCHED; PG8_LDA(At, 0, 0); PG8_STAGE(PG8_SA(1, 1), a1 + hstepA, voffA);
            PG8_WAIT_L(8); PG8_BAR; PG8_WAIT_L(0); PG8_MMA(0, 0, At, B0); PG8_BAR; PG8_SCHED;
            PG8_LDB(B1, 0, 1); PG8_STAGE(PG8_SB(0, 0), b2, voffB);
            PG8_BAR; PG8_WAIT_L(0); PG8_MMA(0, 1, At, B1); PG8_BAR;
            PG8_LDA(At, 0, 1); PG8_STAGE(PG8_SA(0, 0), a2, voffA);
            PG8_BAR; PG8_WAIT_L(0); PG8_MMA(1, 0, At, B0); PG8_BAR; PG8_SCHED;
            PG8_STAGE(PG8_SB(0, 1), b2 + hstepB, voffB);
            PG8_WAIT_V(6); PG8_BAR; PG8_MMA(1, 1, At, B1); PG8_BAR;
            PG8_LDB(B0, 1, 0); PG8_SCHED; PG8_LDA(At, 1, 0); PG8_STAGE(PG8_SA(0, 1), a2 + hstepA, voffA);
            PG8_WAIT_L(8); PG8_BAR; PG8_WAIT_L(0); PG8_MMA(0, 0, At, B0); PG8_BAR; PG8_SCHED;
            PG8_LDB(B1, 1, 1); PG8_STAGE(PG8_SB(1, 0), b3, voffB);
            PG8_BAR; PG8_WAIT_L(0); PG8_MMA(0, 1, At, B1); PG8_BAR;
            PG8_LDA(At, 1, 1); PG8_STAGE(PG8_SA(1, 0), a3, voffA);
            PG8_BAR; PG8_WAIT_L(0); PG8_MMA(1, 0, At, B0); PG8_BAR; PG8_SCHED;
            PG8_STAGE(PG8_SB(1, 1), b3 + hstepB, voffB);
            PG8_WAIT_V(6); PG8_BAR; PG8_MMA(1, 1, At, B1); PG8_BAR;
            }
        }
        if constexpr (ALIGN_EPI) { if (wr == 0) PG8_BAR; }
        if constexpr (!Epi::AFTER_DRAIN) { E(acc, cur, wr, wc, fr, fq); S.done(cur); }
        if (!has_next) break;
#pragma unroll
        for (int a = 0; a < 2; ++a)
#pragma unroll
            for (int b = 0; b < 2; ++b)
#pragma unroll
                for (int m = 0; m < 4; ++m)
#pragma unroll
                    for (int n = 0; n < 2; ++n) acc[a][b][m][n] = (f32x4){0.f, 0.f, 0.f, 0.f};
        cur = nxt; cA = nA; cB = nB; ++ui;
        if constexpr (ALIGN_EPI) { if (wr == 1) PG8_BAR; }
    }
    PG8_WAIT_V(0);
    if constexpr (!ALIGN_EPI) { if (wr == 0) PG8_BAR; }
    PG8_BAR;
    if constexpr (Epi::AFTER_DRAIN) { E.fused(acc, cur, wr, wc, fr, fq, lds, wid, lane); S.done(cur); }
#undef PG8_SA
#undef PG8_SB
#undef PG8_STAGE
#undef PG8_LDA
#undef PG8_LDB
#undef PG8_MMA
#undef PG8_WAIT_V
#undef PG8_WAIT_L
#undef PG8_BAR
#undef PG8_SCHED
}
}
#define XB_TMO      128
#define XB_XCNT(j)  (256  + 64 * (j))
#define XB_XSUB(j)  (1280 + 64 * (j))
#define XB_XGEN(j)  (2304 + 64 * (j))
#define XB_TOP      3328
#define XB_TOPGEN   3392
#define XCD_BAR_WORDS 3456
#define XB_SPIN_CAP (1u << 18)

__device__ __forceinline__ unsigned xb_ld(unsigned* p)              { return __hip_atomic_load(p, __ATOMIC_RELAXED, __HIP_MEMORY_SCOPE_AGENT); }
__device__ __forceinline__ unsigned xb_add(unsigned* p, unsigned v) { return __hip_atomic_fetch_add(p, v, __ATOMIC_RELAXED, __HIP_MEMORY_SCOPE_AGENT); }
__device__ __forceinline__ unsigned xb_xcc_id() { return (unsigned)__builtin_amdgcn_s_getreg((3 << 11) | 20) & 0xFu; }
#define XB_SPIN(cond, bar) do { unsigned _sp = 0; while (cond) { __builtin_amdgcn_s_sleep(1); \
    if ((++_sp & 255u) == 0u) { if (xb_ld(&(bar)[XB_TMO])) break; if (_sp > XB_SPIN_CAP) { atomicAdd(&(bar)[XB_TMO], 1u); break; } } } } while (0)

struct XcdBarrier {
    unsigned* bar; unsigned x;
    volatile LAS unsigned* st;
};

__device__ __forceinline__ XcdBarrier xcd_barrier_post(unsigned* bar, volatile LAS unsigned* st) {
    XcdBarrier b; b.bar = bar; b.x = xb_xcc_id(); b.st = st;
    if (threadIdx.x == 0) (void)xb_add(&bar[XB_XCNT(b.x)], 1u);
    return b;
}
__device__ __forceinline__ void xcd_barrier_complete(unsigned* bar, unsigned x, unsigned& nloc, unsigned& nx) {
    const unsigned G = gridDim.x * gridDim.y * gridDim.z;
    unsigned sum, cnt, mine, sp = 0u;
    for (;;) {
        sum = 0u; cnt = 0u; mine = 0u;
#pragma unroll
        for (unsigned j = 0; j < 16; ++j) { const unsigned c = xb_ld(&bar[XB_XCNT(j)]); sum += c; cnt += (c > 0u) ? 1u : 0u; mine = (j == x) ? c : mine; }
        if (sum == G) break;
        __builtin_amdgcn_s_sleep(1);
        if ((++sp & 255u) == 0u) { if (xb_ld(&bar[XB_TMO])) break; if (sp > XB_SPIN_CAP) { atomicAdd(&bar[XB_TMO], 1u); break; } }
    }
    nloc = mine > 0u ? mine : 1u; nx = cnt > 0u ? cnt : 1u;
}

__device__ __forceinline__ void xcd_barrier(const XcdBarrier& b) {
    asm volatile("s_waitcnt vmcnt(0)" ::: "memory");
    __syncthreads();
    if (threadIdx.x == 0) {
        unsigned* bar = (unsigned*)(WSP() + WS_CTL) + CW_BAR;
        __builtin_amdgcn_s_waitcnt(0);
        unsigned nloc = b.st[0], nx = b.st[1];
        if (nloc == 0u) { xcd_barrier_complete(bar, b.x, nloc, nx); b.st[0] = nloc; b.st[1] = nx; }
        const unsigned old = xb_add(&bar[XB_XSUB(b.x)], 1u);
        const unsigned gen = old / nloc;
        if (old + 1u == (gen + 1u) * nloc) {
            __builtin_amdgcn_fence(__ATOMIC_RELEASE, "agent");
            asm volatile("s_waitcnt vmcnt(0)" ::: "memory");
            const unsigned og = xb_add(&bar[XB_TOP], 1u);
            const unsigned tg = og / nx;
            if (og + 1u == (tg + 1u) * nx) xb_add(&bar[XB_TOPGEN], 1u);
            else XB_SPIN(xb_ld(&bar[XB_TOPGEN]) == tg, bar);
            __builtin_amdgcn_fence(__ATOMIC_ACQUIRE, "agent");
            xb_add(&bar[XB_XGEN(b.x)], 1u);
            asm volatile("s_waitcnt vmcnt(0)" ::: "memory");
        } else {
            XB_SPIN(xb_ld(&bar[XB_XGEN(b.x)]) == gen, bar);
            __builtin_amdgcn_fence(__ATOMIC_ACQUIRE, "agent");
            asm volatile("s_waitcnt vmcnt(0)" ::: "memory");
        }
    }
    __syncthreads();
}

struct Frame {
    LAS unsigned char* lds;
    volatile LAS unsigned* MISC;
    int tid, lane, wave;
    int vcu, G;
};
__device__ __forceinline__ float wave_sum(float v) {
#pragma unroll
    for (int o = 1; o < 64; o <<= 1) v += __shfl_xor(v, o);
    return v;
}

template <bool ROPE_PERM>
__device__ __forceinline__ void p0_transpose_item(const float* W, int K, int N, bf16* WT, int k0, int n0, int drow0, LAS float* scr, int lane) {
#pragma unroll 8
    for (int i = 0; i < 32; ++i) { const int kk = 2 * i + (lane >> 5); scr[kk * 33 + (lane & 31)] = W[(size_t)(k0 + kk) * N + n0 + (lane & 31)]; }
    LDS_WAIT(); asm volatile("" ::: "memory");
    const int c = lane & 7;
#pragma unroll
    for (int j = 0; j < 4; ++j) { const int n = (lane >> 3) + 8 * j; const LAS float* s = scr + (8 * c) * 33 + n;
        v4u o; o.x = pk2(s[0 * 33], s[1 * 33]); o.y = pk2(s[2 * 33], s[3 * 33]); o.z = pk2(s[4 * 33], s[5 * 33]); o.w = pk2(s[6 * 33], s[7 * 33]);
        const int dn = ROPE_PERM ? (8 * ((n & 15) >> 2) + 4 * (n >> 4) + (n & 3)) : n;
        *(GAS v4u*)(WT + (size_t)(drow0 + dn) * K + k0 + 8 * c) = o; }
    LDS_WAIT(); asm volatile("" ::: "memory");
}
__device__ __forceinline__ float ref_cos_sin(double ang, bool want_sin) {
    const double TWO_PI = 6.283185307179586476925286766559; const double k = __builtin_rint(ang / TWO_PI); const double r = ang - k * TWO_PI, r2 = r * r;
    double term = want_sin ? r : 1.0, sum = term;
#pragma unroll
    for (int i = 1; i <= 14; ++i) { const double a = want_sin ? (double)((2 * i) * (2 * i + 1)) : (double)((2 * i - 1) * (2 * i)); term = -term * r2 / a; sum += term; }
    return (float)sum;
}
__constant__ float ROPE_FREQ[16] = {1.000000000e+00f, 5.623413324e-01f, 3.162277639e-01f, 1.778279394e-01f, 1.000000015e-01f, 5.623413250e-02f, 3.162277490e-02f, 1.778279431e-02f,
                                    9.999999776e-03f, 5.623413250e-03f, 3.162277630e-03f, 1.778279431e-03f, 1.000000047e-03f, 5.623413017e-04f, 3.162277571e-04f, 1.778279402e-04f};

__device__ __forceinline__ void p0_prologue(Frame& F) {
    unsigned char* const ws = WSP();
    LAS float* scr = (LAS float*)(F.lds + RING_OFF + F.wave * 8448);
    LAS float* SC = (LAS float*)(F.lds + RING_OFF + 69632);
    for (int i = F.tid; i < 5 * 1024; i += NWAVES * 64) { const float v = (i < 4096) ? IN(1)[i] : IN(3)[i - 4096]; SC[i] = v * __builtin_amdgcn_rcpf(1.0f + __expf(-v)); }
    __syncthreads();
    const int gw = F.vcu * NWAVES + F.wave, NGW = F.G * NWAVES;
    const int lane = F.lane;
    constexpr int T_ADA = 2 * 36 * KSPLIT;
    constexpr int I_WI = (D / 64) * (NWI / 32);
    constexpr int I_WO = (DFF / 64) * (D / 32);
    constexpr int I_WIN = (D / 64) * (NPROJ / 32);
    constexpr int I_WOUT = (D / 64) * (D / 32);
    constexpr int I_WPOOL = 4 * (256 / 64) * (256 / 32);
    constexpr int T_PAD = NPROJ_PAD - NPROJ;
    constexpr int T_ROPE = 16;
    constexpr int NT = T_ADA + 4 * I_WI + 4 * I_WO + I_WIN + I_WOUT + I_WPOOL + T_PAD + T_ROPE;
    bf16* const WI = (bf16*)(ws + WS_WI); bf16* const WO = (bf16*)(ws + WS_WO); bf16* const WIN = (bf16*)(ws + WS_WIN);
    bf16* const WOUT = (bf16*)(ws + WS_WOUT); bf16* const WPOOL = (bf16*)(ws + WS_WPOOL);
    for (int it = gw; it < NT; it += NGW) {
        int r = it;
        if (r < T_ADA) {
            const int l = r / (36 * KSPLIT), rem = r % (36 * KSPLIT), cb = rem / KSPLIT, ks = rem % KSPLIT;
            const int col = cb * 256 + lane * 4, k0 = ks * 64;
            const float* wp = IN(4) + ((size_t)l * 1024 + k0) * 9216 + col;
            f32x4 a0 = {0.f, 0.f, 0.f, 0.f}, a1 = a0, a2 = a0, a3 = a0, a4 = a0;
#pragma unroll 8
            for (int k = 0; k < 64; ++k) { const f32x4 w = *(const f32x4*)(wp + (size_t)k * 9216);
                a0 += w * SC[k0 + k]; a1 += w * SC[1024 + k0 + k]; a2 += w * SC[2048 + k0 + k]; a3 += w * SC[3072 + k0 + k]; a4 += w * SC[4096 + k0 + k]; }
            float* mp = (float*)(ws + WS_MPART) + ((size_t)(ks * 2 + l) * 5) * 9216 + col;
            *(f32x4*)(mp) = a0; *(f32x4*)(mp + 9216) = a1; *(f32x4*)(mp + 2 * 9216) = a2; *(f32x4*)(mp + 3 * 9216) = a3; *(f32x4*)(mp + 4 * 9216) = a4;
            continue;
        }
        r -= T_ADA;
        if (r < 4 * I_WI) {
            const int mi = r / I_WI, item = r % I_WI, kb = item / (NWI / 32), nb = item % (NWI / 32);
            const float* W = ((mi < 2) ? IN(7) : IN(9)) + (size_t)(mi & 1) * D * NWI;
            const int n0 = nb * 32; const int j = (n0 < DFF) ? n0 : n0 - DFF; const int drow0 = 256 * (j / 128) + ((n0 < DFF) ? 0 : 128) + (j % 128);
            p0_transpose_item<false>(W, D, NWI, WI + (size_t)mi * NWI * D, kb * 64, n0, drow0, scr, lane); continue;
        }
        r -= 4 * I_WI;
        if (r < 4 * I_WO) {
            const int mi = r / I_WO, item = r % I_WO, kb = item / (D / 32), nb = item % (D / 32);
            const float* W = ((mi < 2) ? IN(8) : IN(10)) + (size_t)(mi & 1) * DFF * D;
            p0_transpose_item<false>(W, DFF, D, WO + (size_t)mi * D * DFF, kb * 64, nb * 32, nb * 32, scr, lane); continue;
        }
        r -= 4 * I_WO;
        if (r < I_WIN) {
            const int kb = r / (NPROJ / 32), nb = r % (NPROJ / 32), n0 = nb * 32;
            if (n0 < 640) p0_transpose_item<true>(IN(11), D, NPROJ, WIN, kb * 64, n0, n0, scr, lane);
            else p0_transpose_item<false>(IN(11), D, NPROJ, WIN, kb * 64, n0, n0, scr, lane);
            continue;
        }
        r -= I_WIN;
        if (r < I_WOUT) { const int kb = r / (D / 32), nb = r % (D / 32); p0_transpose_item<false>(IN(18), D, D, WOUT, kb * 64, nb * 32, nb * 32, scr, lane); continue; }
        r -= I_WOUT;
        if (r < I_WPOOL) { const int g = r / 32, item = r % 32, kb = item / 8, nb = item % 8;
            p0_transpose_item<false>(IN(19) + (size_t)g * 65536, 256, 256, WPOOL + (size_t)g * 65536, kb * 64, nb * 32, nb * 32, scr, lane); continue; }
        r -= I_WPOOL;
        if (r < T_PAD) { GAS v4u* p = (GAS v4u*)(WIN + (size_t)(NPROJ + r) * D) + lane; p[0] = (v4u){0u, 0u, 0u, 0u}; p[64] = (v4u){0u, 0u, 0u, 0u}; continue; }
        r -= T_PAD;
        { const int e = r * 64 + lane, pos = e >> 4, i = e & 15; const float ang = (float)pos * ROPE_FREQ[i];
          float* rp = (float*)(ws + WS_ROPE); rp[e] = ref_cos_sin((double)ang, false); rp[1024 + e] = ref_cos_sin((double)ang, true); }
    }
}
__device__ __forceinline__ void p1_mtab(Frame& F) {
    unsigned char* const ws = WSP();
    const int gt = F.vcu * (NWAVES * 64) + F.tid, NG = F.G * NWAVES * 64;
    const float* mp = (const float*)(ws + WS_MPART); float* mt = (float*)(ws + WS_MTAB);
    for (int o = gt; o < 2 * 5 * 9216; o += NG) { const int l = o / 46080, rem = o % 46080, r = rem / 9216, n = rem % 9216;
        float v = IN(5)[l * 9216 + n];
#pragma unroll
        for (int ks = 0; ks < KSPLIT; ++ks) v += mp[((size_t)(ks * 2 + l) * 5 + r) * 9216 + n];
        mt[o] = v; }
}
__device__ __forceinline__ void norm_pass(Frame& F, const float* src_x, const float* src_c, int nrows, const float* g, const float* mt  , int si  , bf16* XN) {
    const int gw = F.vcu * NWAVES + F.wave, NGW = F.G * NWAVES;
    f32x4 gv[4];
#pragma unroll
    for (int j = 0; j < 4; ++j) gv[j] = *(const f32x4*)(g + 4 * F.lane + 256 * j);
    for (int m = gw; m < nrows; m += NGW) {
        const bool isc = m >= XROWS; const int r = isc ? 4 : (m >> 12);
        const float* xrow = isc ? src_c + (size_t)(m - XROWS) * D : src_x + (size_t)m * D;
        const float* sh = mt + (size_t)r * 9216 + si * 1024; const float* sc = sh + 1024;
        const GAS f32x4* xr = (const GAS f32x4*)xrow + F.lane;
        f32x4 v[4]; float s = 0.f;
#pragma unroll
        for (int j = 0; j < 4; ++j) { v[j] = xr[64 * j]; s += (v[j].x * v[j].x + v[j].y * v[j].y) + (v[j].z * v[j].z + v[j].w * v[j].w); }
        const float rstd = 1.0f / sqrtf(wave_sum(s) * (1.f / D) + RMS_EPS);
        GAS v2u* o8 = (GAS v2u*)(XN + (size_t)m * D) + F.lane;
#pragma unroll
        for (int j = 0; j < 4; ++j) { const f32x4 scv = *(const f32x4*)(sc + 4 * F.lane + 256 * j), shv = *(const f32x4*)(sh + 4 * F.lane + 256 * j);
            const f32x4 y = (v[j] * rstd) * gv[j] * (scv + 1.0f) + shv;
            v2u w; w.x = pk2(y.x, y.y); w.y = pk2(y.z, y.w); o8[64 * j] = w; }
    }
}
__device__ __forceinline__ void final_norm(Frame& F, float* x, const float* g) {
    const int gw = F.vcu * NWAVES + F.wave, NGW = F.G * NWAVES;
    f32x4 gv[4];
#pragma unroll
    for (int j = 0; j < 4; ++j) gv[j] = *(const f32x4*)(g + 4 * F.lane + 256 * j);
    for (int m = gw; m < XROWS; m += NGW) {
        GAS f32x4* xr = (GAS f32x4*)(x + (size_t)m * D) + F.lane;
        f32x4 v[4]; float s = 0.f;
#pragma unroll
        for (int j = 0; j < 4; ++j) { v[j] = xr[64 * j]; s += (v[j].x * v[j].x + v[j].y * v[j].y) + (v[j].z * v[j].z + v[j].w * v[j].w); }
        const float rstd = 1.0f / sqrtf(wave_sum(s) * (1.f / D) + RMS_EPS);
#pragma unroll
        for (int j = 0; j < 4; ++j) xr[64 * j] = (v[j] * rstd) * gv[j];
    }
}
__device__ __forceinline__ void pool_pass(Frame& F, const bf16* XN, bf16* PL) {
    const int gt = F.vcu * (NWAVES * 64) + F.tid, NG = F.G * NWAVES * 64;
    for (int e = gt; e < XROWS * 128; e += NG) { const int row = e >> 7, ch = e & 127, t = row & 4095, gi = ch >> 5, hw = 1 << gi;
        const int lo = (t - hw < 0) ? 0 : t - hw, hi = (t + hw > SEQ) ? SEQ : t + hw;
        const bf16* base = XN + (size_t)(row - t) * D + ch * 8;
        float s[8] = {0.f, 0.f, 0.f, 0.f, 0.f, 0.f, 0.f, 0.f};
        for (int tt = lo; tt < hi; ++tt) { const v4u w = *(const GAS v4u*)(base + (size_t)tt * D);
            s[0] += bflo(w.x); s[1] += bfhi(w.x); s[2] += bflo(w.y); s[3] += bfhi(w.y); s[4] += bflo(w.z); s[5] += bfhi(w.z); s[6] += bflo(w.w); s[7] += bfhi(w.w); }
        const v4u c = *(const GAS v4u*)(base + (size_t)t * D); const float inv = 1.0f / (float)(hi - lo);
        v4u o; o.x = pk2(s[0] * inv - bflo(c.x), s[1] * inv - bfhi(c.x)); o.y = pk2(s[2] * inv - bflo(c.y), s[3] * inv - bfhi(c.y));
        o.z = pk2(s[4] * inv - bflo(c.z), s[5] * inv - bfhi(c.z)); o.w = pk2(s[6] * inv - bflo(c.w), s[7] * inv - bfhi(c.w));
        *(GAS v4u*)(PL + (size_t)row * D + ch * 8) = o; }
}

typedef LAS const char* lds_cptr;
typedef short v4i16_t __attribute__((ext_vector_type(4)));
__device__ __forceinline__ s16x4 vtr(lds_cptr p) { return __builtin_bit_cast(s16x4, __builtin_amdgcn_ds_read_tr16_b64_v4i16((LAS v4i16_t*)p)); }
__device__ __forceinline__ bf16x8 pack8(const f32x16& p, int b) {
    v4u w; w.x = pk2(p[b], p[b + 1]); w.y = pk2(p[b + 2], p[b + 3]); w.z = pk2(p[b + 4], p[b + 5]); w.w = pk2(p[b + 6], p[b + 7]); return __builtin_bit_cast(bf16x8, w);
}
constexpr int AT_K = 0, AT_V = 16384, AT_WS = 32768;
__device__ __forceinline__ void attn_unit(Frame& F, int b, int n, int g) {
    unsigned char* const ws = WSP();
    const int lane = F.lane, r32 = lane & 31, hi = lane >> 5, w = F.wave;
    const bf16* Q = (const bf16*)(ws + WS_Q); const bf16* K = (const bf16*)(ws + WS_K); const bf16* V = (const bf16*)(ws + WS_V);
    bf16* MIX = (bf16*)(ws + WS_MIX);
    const int head = g * 4 + (w >> 1), qi0 = 64 * (w & 1);
    LAS float* wsf = (LAS float*)(F.lds + AT_WS) + w * 64;
    bf16x8 q[2][4];
#pragma unroll
    for (int sb = 0; sb < 2; ++sb)
#pragma unroll
        for (int d0 = 0; d0 < 4; ++d0) q[sb][d0] = *(const bf16x8*)(Q + (size_t)(b * SEQ + 128 * n + qi0 + 32 * sb + r32) * 512 + head * 64 + 16 * d0 + 8 * hi);
    const float sk = IN(16)[head] * 1.4426950408889634f;
    float mrun[2] = {sk, sk}, lrun[2] = {hi == 0 ? 1.0f : 0.0f, hi == 0 ? 1.0f : 0.0f};
    f32x16 o[2][2];
#pragma unroll
    for (int sb = 0; sb < 2; ++sb)
#pragma unroll
        for (int d0 = 0; d0 < 2; ++d0)
#pragma unroll
            for (int r = 0; r < 16; ++r) o[sb][d0][r] = 0.f;
    const int kt0 = (2 * n - 2 < 0) ? 0 : 2 * n - 2, kt1 = (2 * n + 3 > 63) ? 63 : 2 * n + 3, nt = 4 + (kt1 - kt0 + 1);
    const int vrow = 16 * (w & 3) + (lane >> 2), vd = (w >> 2) * 32 + (lane & 3) * 8;
    v4u kreg, vreg;
#define AT_LOAD(t) do { const int rowt = ((t) < 4) ? (XROWS + b * CTXL + 64 * (t)) : (b * SEQ + 64 * (kt0 + (t) - 4)); \
        kreg = *(const GAS v4u*)(K + (size_t)(rowt + lane) * 128 + g * 64 + w * 8); vreg = *(const GAS v4u*)(V + (size_t)(rowt + vrow) * 128 + g * 64 + vd); } while (0)
    AT_LOAD(0);
    for (int t = 0; t < nt; ++t) {
        const int buf = t & 1;
        *(LAS v4u*)(F.lds + AT_K + buf * 8192 + w * 1024 + lane * 16) = kreg;
        *(LAS v4u*)(F.lds + AT_V + buf * 8192 + w * 1024 + lane * 16) = vreg;
        if (t + 1 < nt) AT_LOAD(t + 1);
        __syncthreads();
        const bool band = t >= 4; const int kbase = 64 * (kt0 + t - 4);
        const lds_cptr kb = (lds_cptr)(F.lds + AT_K + buf * 8192) + hi * 1024 + r32 * 16;
        const lds_cptr vp = (lds_cptr)(F.lds + AT_V + buf * 8192) + ((lane >> 4) & 1) * 32 + (lane & 3) * 8 + (4 * hi + ((lane & 15) >> 2)) * 64;
#pragma unroll
        for (int sb = 0; sb < 2; ++sb) {
            const int qlo = 128 * n + qi0 + 32 * sb;
            if (band && (kbase + 63 < qlo - 128 || kbase > qlo + 31 + 128)) continue;
            f32x16 p0, p1;
#pragma unroll
            for (int r = 0; r < 16; ++r) { p0[r] = 0.f; p1[r] = 0.f; }
#pragma unroll
            for (int d0 = 0; d0 < 4; ++d0) { const bf16x8 b0 = *(const LAS bf16x8*)(kb + d0 * 2048), b1 = *(const LAS bf16x8*)(kb + d0 * 2048 + 512);
                p0 = mfma32(b0, q[sb][d0], p0); p1 = mfma32(b1, q[sb][d0], p1); }
            if (band) { const int qpos = qlo + r32;
#pragma unroll
                for (int r = 0; r < 16; ++r) { const int kp = kbase + crow(r, hi); int d0_ = kp - qpos; d0_ = d0_ < 0 ? -d0_ : d0_; int d1_ = kp + 32 - qpos; d1_ = d1_ < 0 ? -d1_ : d1_;
                    if (d0_ > 128) p0[r] = -INFINITY; if (d1_ > 128) p1[r] = -INFINITY; } }
            float rm = fmaxf(p0[0], p1[0]);
#pragma unroll
            for (int r = 1; r < 16; ++r) rm = fmaxf(rm, fmaxf(p0[r], p1[r]));
            rm = fmaxf(rm, __shfl_xor(rm, 32));
            const float mnew = fmaxf(mrun[sb], rm), alpha = __builtin_amdgcn_exp2f(mrun[sb] - mnew); mrun[sb] = mnew;
            float rs = 0.f;
#pragma unroll
            for (int r = 0; r < 16; ++r) { p0[r] = __builtin_amdgcn_exp2f(p0[r] - mnew); p1[r] = __builtin_amdgcn_exp2f(p1[r] - mnew); rs += p0[r] + p1[r]; }
            lrun[sb] = lrun[sb] * alpha + rs;
            if (hi == 0) wsf[r32] = alpha;
            LDS_WAIT();
#pragma unroll
            for (int r = 0; r < 16; ++r) { const float a = wsf[crow(r, hi)]; o[sb][0][r] *= a; o[sb][1][r] *= a; }
            const bf16x8 pa0 = pack8(p0, 0), pa1 = pack8(p0, 8), pa2 = pack8(p1, 0), pa3 = pack8(p1, 8);
#pragma unroll
            for (int d0 = 0; d0 < 2; ++d0) {
                s16x4 lo[4], hh[4];
#pragma unroll
                for (int ks = 0; ks < 4; ++ks) { lo[ks] = vtr(vp + d0 * 4096 + ks * 1024); hh[ks] = vtr(vp + d0 * 4096 + ks * 1024 + 512); }
#define AT_PK(k) (bf16x8){lo[k][0], lo[k][1], lo[k][2], lo[k][3], hh[k][0], hh[k][1], hh[k][2], hh[k][3]}
                o[sb][d0] = mfma32(pa0, AT_PK(0), o[sb][d0]); o[sb][d0] = mfma32(pa1, AT_PK(1), o[sb][d0]);
                o[sb][d0] = mfma32(pa2, AT_PK(2), o[sb][d0]); o[sb][d0] = mfma32(pa3, AT_PK(3), o[sb][d0]);
#undef AT_PK
            }
            LDS_WAIT();
        }
    }
#undef AT_LOAD
#pragma unroll
    for (int sb = 0; sb < 2; ++sb) {
        const float lt = lrun[sb] + __shfl_xor(lrun[sb], 32);
        if (hi == 0) wsf[r32] = 1.0f / lt;
        LDS_WAIT();
        bf16* orow = MIX + (size_t)(b * SEQ + 128 * n + qi0 + 32 * sb) * D + head * 64 + r32;
#pragma unroll
        for (int r = 0; r < 16; ++r) { const float inv = wsf[crow(r, hi)]; const int qr = crow(r, hi);
            orow[(size_t)qr * D] = (bf16)f2bf(o[sb][0][r] * inv); orow[(size_t)qr * D + 32] = (bf16)f2bf(o[sb][1][r] * inv); }
        LDS_WAIT();
    }
    __syncthreads();
}

constexpr int GL_QT = 0, GL_KT = 9216, GL_KET = 18432, GL_VT = 27648, GL_ST = 46080, GL_GRP = 82944, GL_DEC = 84992, GL_ZG = 85248, GL_OUT = 89344, GL_WA = 123136, GL_RS = 144;
__device__ __forceinline__ float logsig16(float x) { return (fminf(x, 0.f) - __logf(1.0f + __expf(-fabsf(x)))) * 0.0625f; }
template <bool OUT>
__device__ __forceinline__ void gla_unit(Frame& F, int b, int h, int seg) {
    unsigned char* const ws = WSP();
    const int tid = F.tid, lane = F.lane, r32 = lane & 31, hi = lane >> 5, w = F.wave;
    const int d = tid & 63, ig = w, ti = w >> 2, vi = w & 3, di = w >> 2;
    const int rowb = (seg < 16) ? b * SEQ + 256 * seg : XROWS + b * CTXL;
    const bf16* QB = (const bf16*)(ws + WS_QB); const bf16* KB = (const bf16*)(ws + WS_KB); const bf16* VB = (const bf16*)(ws + WS_VB); const bf16* RB = (const bf16*)(ws + WS_RB);
    const float* ZG = (const float*)(ws + WS_ZG); bf16* MIX = (bf16*)(ws + WS_MIX);
    float* GS = (float*)(ws + WS_GS); float* GD = (float*)(ws + WS_GD);
    float* OF = (float*)(ws + WS_XN);
    LAS unsigned char* L = F.lds;
    for (int dir = 0; dir < 2; ++dir) {
        const float* wa2 = dir ? IN(14) : IN(12); const float* ba2 = dir ? IN(15) : IN(13);
        __syncthreads();
        { LAS float* wl = (LAS float*)(L + GL_WA);
          for (int i = tid; i < 1024; i += NWAVES * 64) wl[i] = wa2[(i >> 6) * 256 + h * 64 + (i & 63)];
          if (tid < 64) wl[1024 + tid] = ba2[h * 64 + tid]; }
        const size_t sidx = ((size_t)(seg * 16 + b * 4 + h) * 2 + dir);
        f32x16 S;
#pragma unroll
        for (int r = 0; r < 16; ++r) S[r] = OUT ? GS[sidx * 8192 + (size_t)(32 * di + crow(r, hi)) * 128 + 32 * vi + r32] : 0.f;
#pragma unroll
        for (int q4 = 0; q4 < 4; ++q4) { v2u wv; wv.x = pk2(S[4 * q4], S[4 * q4 + 1]); wv.y = pk2(S[4 * q4 + 2], S[4 * q4 + 3]);
            *(LAS v2u*)(L + GL_ST + (32 * vi + r32) * GL_RS + (32 * di + 8 * q4 + 4 * hi) * 2) = wv; }
        float gsum = 0.f;
        for (int cc = 0; cc < 4; ++cc) {
            const int c = dir ? 3 - cc : cc; const int rowc = rowb + 64 * c;
            const int stc = (cc & 1) * 18432, stn = ((cc + 1) & 1) * 18432;
            __syncthreads();
            { const int tok = tid >> 3, r0 = (tid & 7) * 2; const float* zp = ZG + (size_t)(rowc + tok) * 32 + dir * 16 + r0;
              LAS float* zs = (LAS float*)(L + GL_ZG) + tok * 16 + r0; zs[0] = zp[0]; zs[1] = zp[1]; }
            __syncthreads();
            float la[8];
            { const LAS float* wl = (const LAS float*)(L + GL_WA);
#pragma unroll
              for (int e = 0; e < 8; ++e) la[e] = wl[1024 + d];
#pragma unroll
              for (int r = 0; r < 16; ++r) { const float wv = wl[r * 64 + d];
#pragma unroll
                for (int e = 0; e < 8; ++e) la[e] += ((const LAS float*)(L + GL_ZG))[(8 * ig + e) * 16 + r] * wv; }
#pragma unroll
              for (int e = 0; e < 8; ++e) la[e] = logsig16(la[e]); }
            if (dir == 0) {
#pragma unroll
                for (int e = 1; e < 8; ++e) la[e] += la[e - 1];
            } else {
#pragma unroll
                for (int e = 6; e >= 0; --e) la[e] += la[e + 1];
            }
            const float tot = dir ? la[0] : la[7];
            ((LAS float*)(L + GL_GRP))[ig * 64 + d] = tot;
            __syncthreads();
            float off = 0.f, gtot = 0.f;
#pragma unroll
            for (int j = 0; j < 8; ++j) { const float gj = ((const LAS float*)(L + GL_GRP))[j * 64 + d]; gtot += gj; if (dir ? (j > ig) : (j < ig)) off += gj; }
            gsum += gtot;
            { const bf16* qp = QB + (size_t)(rowc + 8 * ig) * 256 + h * 64 + d; const bf16* kp = KB + (size_t)(rowc + 8 * ig) * 256 + h * 64 + d;
              unsigned kew[4];
#pragma unroll
              for (int e2 = 0; e2 < 4; ++e2) { float kel[2];
#pragma unroll
                for (int e1 = 0; e1 < 2; ++e1) { const int e = 2 * e2 + e1; const int tok = 8 * ig + e; const float gg = la[e] + off;
                    const float qv = bf2f(qp[e * 256]), kv = bf2f(kp[e * 256]);
                    const float eg = __expf(gg), eng = __expf(-gg), ee = __expf(gtot - gg);
                    *(LAS bf16*)(L + GL_QT + tok * GL_RS + d * 2) = (bf16)f2bf(qv * 0.125f * eg);
                    *(LAS bf16*)(L + GL_KT + tok * GL_RS + d * 2) = (bf16)f2bf(kv * eng);
                    kel[e1] = kv * ee; }
                kew[e2] = pk2(kel[0], kel[1]); }
              *(LAS v4u*)(L + GL_KET + d * GL_RS + (8 * ig) * 2) = (v4u){kew[0], kew[1], kew[2], kew[3]}; }
            if (ig == 0) ((LAS float*)(L + GL_DEC))[d] = __expf(gtot);
            { const int v = tid & 127, tg = tid >> 7;
              const bf16* vp = VB + (size_t)(rowc + 16 * tg) * 512 + h * 128 + v;
#pragma unroll
              for (int half = 0; half < 2; ++half) { unsigned pw[4];
#pragma unroll
                for (int e2 = 0; e2 < 4; ++e2) { const int tk = 8 * half + 2 * e2; const unsigned lo = vp[tk * 512], hh = vp[(tk + 1) * 512]; pw[e2] = lo | (hh << 16); }
                *(LAS v4u*)(L + GL_VT + v * GL_RS + (16 * tg + 8 * half) * 2) = (v4u){pw[0], pw[1], pw[2], pw[3]}; } }
            __syncthreads();
            if (OUT) {
                f32x16 X0, X1, oo;
#pragma unroll
                for (int r = 0; r < 16; ++r) { X0[r] = 0.f; X1[r] = 0.f; oo[r] = 0.f; }
                bf16x8 bq[4];
#pragma unroll
                for (int s = 0; s < 4; ++s) { bq[s] = *(const LAS bf16x8*)(L + GL_QT + (32 * ti + r32) * GL_RS + (16 * s + 8 * hi) * 2);
                    const bf16x8 a0 = *(const LAS bf16x8*)(L + GL_KT + r32 * GL_RS + (16 * s + 8 * hi) * 2), a1 = *(const LAS bf16x8*)(L + GL_KT + (32 + r32) * GL_RS + (16 * s + 8 * hi) * 2);
                    X0 = mfma32(a0, bq[s], X0); X1 = mfma32(a1, bq[s], X1); }
                const int icol = 32 * ti + r32;
#pragma unroll
                for (int r = 0; r < 16; ++r) { const int j0 = crow(r, hi), j1 = 32 + crow(r, hi);
                    if (dir ? (j0 < icol) : (j0 > icol)) X0[r] = 0.f; if (dir ? (j1 < icol) : (j1 > icol)) X1[r] = 0.f; }
#pragma unroll
                for (int ks = 0; ks < 4; ++ks) { const bf16x8 pa = (ks < 2) ? pack8(X0, 8 * (ks & 1)) : pack8(X1, 8 * (ks & 1));
                    const LAS unsigned char* vr = L + GL_VT + (32 * vi + r32) * GL_RS + (16 * ks + 4 * hi) * 2;
                    const v2u lo = *(const LAS v2u*)vr, hh = *(const LAS v2u*)(vr + 16);
                    const bf16x8 vf = __builtin_bit_cast(bf16x8, (v4u){lo.x, lo.y, hh.x, hh.y});
                    oo = mfma32(pa, vf, oo); }
#pragma unroll
                for (int s = 0; s < 4; ++s) { const bf16x8 bs = *(const LAS bf16x8*)(L + GL_ST + stc + (32 * vi + r32) * GL_RS + (16 * s + 8 * hi) * 2); oo = mfma32(bq[s], bs, oo); }
                float* ofp = OF + (size_t)(rowc + 32 * ti) * 512 + h * 128 + 32 * vi + r32;
                if (dir == 0) {
#pragma unroll
                    for (int r = 0; r < 16; ++r) ofp[crow(r, hi) * 512] = oo[r];
                } else {
#pragma unroll
                    for (int r = 0; r < 16; ++r) ((LAS float*)(L + GL_OUT))[(32 * ti + crow(r, hi)) * 132 + 32 * vi + r32] = oo[r] + ofp[crow(r, hi) * 512];
                }
            }
            {
#pragma unroll
                for (int r = 0; r < 16; ++r) S[r] *= ((const LAS float*)(L + GL_DEC))[32 * di + crow(r, hi)];
#pragma unroll
                for (int s = 0; s < 4; ++s) { const bf16x8 ak = *(const LAS bf16x8*)(L + GL_KET + (32 * di + r32) * GL_RS + (16 * s + 8 * hi) * 2), bv = *(const LAS bf16x8*)(L + GL_VT + (32 * vi + r32) * GL_RS + (16 * s + 8 * hi) * 2);
                    S = mfma32(ak, bv, S); }
#pragma unroll
                for (int q4 = 0; q4 < 4; ++q4) { v2u wv; wv.x = pk2(S[4 * q4], S[4 * q4 + 1]); wv.y = pk2(S[4 * q4 + 2], S[4 * q4 + 3]);
                    *(LAS v2u*)(L + GL_ST + stn + (32 * vi + r32) * GL_RS + (32 * di + 8 * q4 + 4 * hi) * 2) = wv; }
            }
            if (OUT && dir == 1) {
                __syncthreads();
                const int tok = tid >> 3, vs = 16 * (tid & 7);
                f32x4 ov[4]; float ss = 0.f;
#pragma unroll
                for (int j = 0; j < 4; ++j) { ov[j] = *(const LAS f32x4*)(L + GL_OUT + (tok * 132 + vs + 4 * j) * 4); ss += (ov[j].x * ov[j].x + ov[j].y * ov[j].y) + (ov[j].z * ov[j].z + ov[j].w * ov[j].w); }
                ss += __shfl_xor(ss, 1); ss += __shfl_xor(ss, 2); ss += __shfl_xor(ss, 4);
                const float rstd = 1.0f / sqrtf(ss * (1.f / 128.f) + RMS_EPS);
                const bf16* rp = RB + (size_t)(rowc + tok) * 512 + h * 128 + vs;
                const v4u rw0 = *(const GAS v4u*)rp, rw1 = *(const GAS v4u*)(rp + 8);
                const unsigned rws[8] = {rw0.x, rw0.y, rw0.z, rw0.w, rw1.x, rw1.y, rw1.z, rw1.w};
                const float* gp = IN(17) + vs;
                unsigned ow[8];
#pragma unroll
                for (int j = 0; j < 4; ++j) { const f32x4 gg = *(const f32x4*)(gp + 4 * j);
                    const float r0 = bflo(rws[2 * j]), r1 = bfhi(rws[2 * j]), r2 = bflo(rws[2 * j + 1]), r3 = bfhi(rws[2 * j + 1]);
                    ow[2 * j] = pk2(ov[j].x * rstd * gg.x * pg8::silu_f(r0), ov[j].y * rstd * gg.y * pg8::silu_f(r1));
                    ow[2 * j + 1] = pk2(ov[j].z * rstd * gg.z * pg8::silu_f(r2), ov[j].w * rstd * gg.w * pg8::silu_f(r3)); }
                bf16* op = MIX + (size_t)(rowc + tok) * D + 512 + h * 128 + vs;
                *(GAS v4u*)op = (v4u){ow[0], ow[1], ow[2], ow[3]}; *(GAS v4u*)(op + 8) = (v4u){ow[4], ow[5], ow[6], ow[7]};
            }
        }
        if (!OUT) {
#pragma unroll
            for (int r = 0; r < 16; ++r) GS[sidx * 8192 + (size_t)(32 * di + crow(r, hi)) * 128 + 32 * vi + r32] = S[r];
            if (ig == 0) GD[sidx * 64 + d] = __expf(gsum);
        }
    }
    __syncthreads();
}
__device__ __forceinline__ void gla_scan(Frame& F) {
    unsigned char* const ws = WSP();
    const int gt = F.vcu * (NWAVES * 64) + F.tid, NG = F.G * NWAVES * 64;
    float* GS = (float*)(ws + WS_GS); const float* GD = (const float*)(ws + WS_GD);
    for (int e = gt; e < 32 * 8192; e += NG) { const int seq = e >> 13, el = e & 8191, bh = seq >> 1, dir = seq & 1, dd = el >> 7;
        float ds[17], dc[17];
#pragma unroll
        for (int st = 0; st < 17; ++st) { const int seg = (st == 0) ? 16 : (dir ? 16 - st : st - 1); const size_t sidx = ((size_t)(seg * 16 + bh) * 2 + dir);
            ds[st] = GS[sidx * 8192 + el]; dc[st] = GD[sidx * 64 + dd]; }
        float S = 0.f;
#pragma unroll
        for (int st = 0; st < 17; ++st) { const int seg = (st == 0) ? 16 : (dir ? 16 - st : st - 1); const size_t sidx = ((size_t)(seg * 16 + bh) * 2 + dir);
            GS[sidx * 8192 + el] = S; S = dc[st] * S + ds[st]; }
    }
}


struct Args { const float* in[22]; float* out; unsigned char* ws; };
__global__ void __launch_bounds__(NWAVES * 64, 2) dit_fwd(Args args) {
    extern __shared__ __attribute__((aligned(16))) unsigned char lds[];
    Frame F;
    F.lds = (LAS unsigned char*)lds;
    F.MISC = (volatile LAS unsigned*)(F.lds + MISC_OFF);
    F.tid = threadIdx.x; F.lane = F.tid & 63; F.wave = __builtin_amdgcn_readfirstlane(F.tid >> 6);
    F.G = gridDim.x; { const int bx = blockIdx.x; F.vcu = (F.G % 8 == 0) ? (bx % 8) * (F.G / 8) + bx / 8 : bx; }
    for (int u = F.tid; u < (LDS_BYTES - LDSCTL_OFF) / 4; u += NWAVES * 64) ((LAS unsigned*)(F.lds + LDSCTL_OFF))[u] = 0u;
    __syncthreads();
    XcdBarrier bar = xcd_barrier_post((unsigned*)(WSP() + WS_CTL) + CW_BAR, F.MISC + 8);
    const int bid = (int)blockIdx.x;
    constexpr int NPH = 2 + 24 + 1;
    for (int ph = 0; ph < NPH; ++ph) {
        unsigned char* const ws = WSP();
        { int t_ = threadIdx.x; asm volatile("" : "+v"(t_)); F.tid = t_; F.lane = t_ & 63; F.wave = __builtin_amdgcn_readfirstlane(t_ >> 6); }
        if (ph == 0) {
#ifndef NO_P0
            p0_prologue(F);
#endif
        } else if (ph == 1) { p1_mtab(F);
        } else if (ph == NPH - 1) { final_norm(F, OUTP(), IN(21));
        } else {
            const int l = (ph - 2) / 12, st = (ph - 2) % 12;
            const float* mt = (const float*)(ws + WS_MTAB) + (size_t)l * 5 * 9216;
            const int nrows = (l == 0) ? MROWS : XROWS;
            bf16* const XN = (bf16*)(ws + WS_XN); bf16* const HB = (bf16*)(ws + WS_H); bf16* const MIX = (bf16*)(ws + WS_MIX);
            float* const X = OUTP();
            if (st == 0 || st == 3 || st == 9) {
                const float* sx = (st == 0 && l == 0) ? IN(0) : X; const float* sc = (st == 0) ? IN(2) : (const float*)(ws + WS_CTX1);
                norm_pass(F, sx, sc, (st == 9) ? XROWS : nrows, IN(6) + (size_t)l * 3 * D + (st / 3 > 2 ? 2 : st / 3) * D, mt, (st == 0) ? 0 : (st == 3 ? 3 : 6), XN);
            } else if (st == 1 || st == 10) {
                const int M = (st == 1) ? nrows : XROWS;
                pg8::Gemm g{XN, (const bf16*)(ws + WS_WI) + (size_t)((st == 1 ? 0 : 2) + l) * NWI * D, M, NWI, D, D, 0}; pg8::StaticOrder S; S.init(M, NWI, F.G, bid);
                pg8::EpiSwiGLU E{};
                pg8::gemm_phase<pg8::EpiSwiGLU, pg8::StaticOrder, true, true>(F.lds + RING_OFF, g, S, E);
            } else if (st == 2 || st == 11) {
                const int M = (st == 2) ? nrows : XROWS;
                pg8::Gemm g{HB, (const bf16*)(ws + WS_WO) + (size_t)((st == 2 ? 0 : 2) + l) * D * DFF, M, D, DFF, DFF, 0}; pg8::StaticOrder S; S.init(M, D, F.G, bid);
                pg8::EpiRes E{(st == 2 && l == 0) ? 1 : 0, l * 5 * 9216 + (st == 2 ? 2 : 8) * 1024, 0, 0.5f};
                pg8::gemm_phase<pg8::EpiRes, pg8::StaticOrder, true, true>(F.lds + RING_OFF, g, S, E);
            } else if (st == 4) {
                if (l == 0) {
                    pg8::Gemm g{XN, (const bf16*)(ws + WS_WIN), MROWS, NPROJ_PAD, D, D, 0}; pg8::StaticOrder S; S.init(MROWS, NPROJ_PAD, F.G, bid);
                    pg8::EpiProj E{};
                    pg8::gemm_phase<pg8::EpiProj, pg8::StaticOrder, true, true>(F.lds + RING_OFF, g, S, E);
                } else pool_pass(F, XN, MIX);
            } else if (st == 5) {
                if (l == 0) {
#ifndef NO_ATTN
                    for (int u = bid; u < 256; u += F.G) attn_unit(F, u >> 6, (u >> 1) & 31, u & 1);
#endif
#ifndef NO_GLAA
                    for (int u = bid; u < 272; u += F.G) gla_unit<false>(F, (u & 15) >> 2, u & 3, u >> 4);
#endif
                }
            } else if (st == 6) { if (l == 0) gla_scan(F);
            } else if (st == 7) {
#ifndef NO_GLAC
                if (l == 0) for (int u = bid; u < 256; u += F.G) gla_unit<true>(F, (u & 15) >> 2, u & 3, u >> 4);
#endif
            } else if (st == 8) {
                pg8::Gemm g{MIX, (l == 0) ? (const bf16*)(ws + WS_WOUT) : (const bf16*)(ws + WS_WPOOL), XROWS, D, (l == 0) ? D : 256, D, (l == 0) ? 0 : 256}; pg8::StaticOrder S; S.init(XROWS, D, F.G, bid);
                pg8::EpiRes E{0, l * 5 * 9216 + 5 * 1024, l, 1.0f};
                pg8::gemm_phase<pg8::EpiRes, pg8::StaticOrder, true, true>(F.lds + RING_OFF, g, S, E);
            }
            if (l == 1 && (st == 5 || st == 6 || st == 7)) continue;
        }
        xcd_barrier(bar);
    }
}

extern "C" void kernel_launch(void* const* d_in, const int* in_sizes, int n_in, void* d_out, int out_size, void* d_ws, size_t ws_size, hipStream_t stream) {
    static int grid = 0;
    if (grid == 0) {
        if (n_in != 22 || out_size != XROWS * D || ws_size < WS_END) { fprintf(stderr, "kernel_launch: unexpected problem (n_in %d out %d ws %zu); nothing launched\n", n_in, out_size, ws_size); grid = -1; return; }
        int dev = 0, cus = 0, per_cu = 0;
        if (hipGetDevice(&dev) != hipSuccess || hipDeviceGetAttribute(&cus, hipDeviceAttributeMultiprocessorCount, dev) != hipSuccess) { grid = -1; return; }
        if (hipFuncSetAttribute((const void*)dit_fwd, hipFuncAttributeMaxDynamicSharedMemorySize, LDS_BYTES) != hipSuccess) { fprintf(stderr, "kernel_launch: hipFuncSetAttribute failed\n"); grid = -1; return; }
        if (hipOccupancyMaxActiveBlocksPerMultiprocessor(&per_cu, (const void*)dit_fwd, NWAVES * 64, LDS_BYTES) != hipSuccess || per_cu < 1)
            fprintf(stderr, "kernel_launch: note: occupancy query reports %d workgroups per CU\n", per_cu);
        (void)hipGetLastError();
        grid = cus;
    }
    if (grid < 0) return;
    if (hipMemsetAsync((char*)d_ws + WS_CTL, 0, CTL_ZERO_BYTES, stream) != hipSuccess) { fprintf(stderr, "kernel_launch: hipMemsetAsync failed\n"); return; }
    Args a{};
    for (int i = 0; i < 22; ++i) a.in[i] = (const float*)d_in[i];
    a.out = (float*)d_out; a.ws = (unsigned char*)d_ws;
    hipLaunchKernelGGL(dit_fwd, dim3(grid), dim3(NWAVES * 64), LDS_BYTES, stream, a);
}
```
